# Optimizing an MI355X kernel written in HIP

```python
import jax, jax.numpy as jnp
from jax import lax
import numpy as np

D_MODEL = 4096
BATCH = 2
SEQ = 4096
DEPTH = 1

CHUNK = 64
N_LEFT_CHUNKS = 8
BAND = (N_LEFT_CHUNKS + 1) * CHUNK
MIX_WIDTH = D_MODEL
ATT_WIDTH = MIX_WIDTH // 2
RNN_WIDTH = MIX_WIDTH - ATT_WIDTH
HEAD_DIM = 128
N_ATT_HEADS = ATT_WIDTH // HEAD_DIM
N_RNN_BLOCKS = 16
RNN_BLOCK = RNN_WIDTH // N_RNN_BLOCKS
REL_CLIP = 128
N_REL = 2 * REL_CLIP + 1
CONV_WIDTH = 4
LRU_C = 8.0
D_FF = ((8 * D_MODEL // 3 + 255) // 256) * 256
PLE_DIM = 256
IN_PROJ_WIDTH = 3 * ATT_WIDTH + 2 * RNN_WIDTH
EPS = 1e-6
NEG_INF = -1e30

kernel_name = "hybrid_chunk_attn_rglru_macaron_layer"


def rms_norm(x, g):
    x32 = x.astype(jnp.float32)
    y = x32 * lax.rsqrt(jnp.mean(x32 * x32, axis=-1, keepdims=True) + EPS)
    return (y * g.astype(jnp.float32)).astype(x.dtype)


def swiglu(x, w_gate, w_up, w_down):
    return (jax.nn.silu(x @ w_gate) * (x @ w_up)) @ w_down


def chunked_rel_attention(q, k, v, rel_bias):
    B, S, H, Dh = q.shape
    n_chunks = S // CHUNK
    pad = N_LEFT_CHUNKS * CHUNK
    k_pad = jnp.pad(k, ((0, 0), (pad, 0), (0, 0), (0, 0)))
    v_pad = jnp.pad(v, ((0, 0), (pad, 0), (0, 0), (0, 0)))
    q_off = jnp.arange(CHUNK)[:, None]
    k_off = jnp.arange(BAND)[None, :] - pad
    rel_idx = jnp.clip(q_off - k_off, -REL_CLIP, REL_CLIP) + REL_CLIP
    bias = rel_bias.astype(jnp.float32)[:, rel_idx]
    scale = HEAD_DIM ** -0.5

    def one_chunk(c):
        start = c * CHUNK
        q_c = lax.dynamic_slice_in_dim(q, start, CHUNK, axis=1)
        k_c = lax.dynamic_slice_in_dim(k_pad, start, BAND, axis=1)
        v_c = lax.dynamic_slice_in_dim(v_pad, start, BAND, axis=1)
        s = jnp.einsum('bqhd,bkhd->bhqk', q_c, k_c).astype(jnp.float32) * scale + bias
        valid = (start + k_off) >= 0
        s = jnp.where(valid[None, None], s, NEG_INF)
        w = jax.nn.softmax(s, axis=-1).astype(v.dtype)
        return jnp.einsum('bhqk,bkhd->bqhd', w, v_c)

    out = lax.map(one_chunk, jnp.arange(n_chunks))
    return out.transpose(1, 0, 2, 3, 4).reshape(B, S, H * Dh)


def causal_depthwise_conv(x, w, b):
    S = x.shape[1]
    xp = jnp.pad(x, ((0, 0), (CONV_WIDTH - 1, 0), (0, 0)))
    out = b + xp[:, 0:S] * w[0]
    for j in range(1, CONV_WIDTH):
        out = out + xp[:, j:j + S] * w[j]
    return out


def rg_lru(x, w_a, b_a, w_i, b_i, lam):
    B, S, C = x.shape
    xb = x.reshape(B, S, N_RNN_BLOCKS, RNN_BLOCK)
    r = jax.nn.sigmoid(jnp.einsum('bsnc,ncd->bsnd', xb, w_a).reshape(B, S, C) + b_a)
    i = jax.nn.sigmoid(jnp.einsum('bsnc,ncd->bsnd', xb, w_i).reshape(B, S, C) + b_i)
    log_a = -LRU_C * r.astype(jnp.float32) * jax.nn.softplus(-lam.astype(jnp.float32))
    a = jnp.exp(log_a)
    gated_x = jnp.sqrt(-jnp.expm1(2.0 * log_a)) * (i * x).astype(jnp.float32)

    def combine(left, right):
        a1, b1 = left
        a2, b2 = right
        return a1 * a2, a2 * b1 + b2

    _, h = lax.associative_scan(combine, (a, gated_x), axis=1)
    return h.astype(x.dtype)


def setup_inputs(seed: int = 0) -> dict:
    key = jax.random.key(seed)
    ks = jax.random.split(key, 32)

    def dense(k, shape, fan_in):
        return jax.random.normal(k, shape, jnp.float32) * (fan_in ** -0.5)

    def gain(k):
        return 1.0 + 0.05 * jax.random.normal(k, (DEPTH, D_MODEL), jnp.float32)

    u = jax.random.uniform(ks[20], (DEPTH, RNN_WIDTH), jnp.float32, 0.9, 0.999)
    return {
        "x": jax.random.normal(ks[0], (BATCH, SEQ, D_MODEL), jnp.float32),
        "p": jax.random.normal(ks[1], (DEPTH, BATCH, SEQ, PLE_DIM), jnp.float32),
        "ffn1_pre_g": gain(ks[2]),
        "ffn1_w_gate": dense(ks[3], (DEPTH, D_MODEL, D_FF), D_MODEL),
        "ffn1_w_up": dense(ks[4], (DEPTH, D_MODEL, D_FF), D_MODEL),
        "ffn1_w_down": dense(ks[5], (DEPTH, D_FF, D_MODEL), D_FF),
        "ffn1_post_g": gain(ks[6]),
        "mix_pre_g": gain(ks[7]),
        "w_in": dense(ks[8], (DEPTH, D_MODEL, IN_PROJ_WIDTH), D_MODEL),
        "rel_bias": 0.5 * jax.random.normal(ks[9], (DEPTH, N_ATT_HEADS, N_REL), jnp.float32),
        "conv_w": dense(ks[10], (DEPTH, CONV_WIDTH, RNN_WIDTH), CONV_WIDTH),
        "conv_b": 0.02 * jax.random.normal(ks[11], (DEPTH, RNN_WIDTH), jnp.float32),
        "lru_w_a": dense(ks[12], (DEPTH, N_RNN_BLOCKS, RNN_BLOCK, RNN_BLOCK), RNN_BLOCK),
        "lru_b_a": 0.02 * jax.random.normal(ks[13], (DEPTH, RNN_WIDTH), jnp.float32),
        "lru_w_i": dense(ks[14], (DEPTH, N_RNN_BLOCKS, RNN_BLOCK, RNN_BLOCK), RNN_BLOCK),
        "lru_b_i": 0.02 * jax.random.normal(ks[15], (DEPTH, RNN_WIDTH), jnp.float32),
        "lru_lambda": jnp.log(u) - jnp.log1p(-u),
        "w_out": dense(ks[16], (DEPTH, MIX_WIDTH, D_MODEL), MIX_WIDTH),
        "mix_post_g": gain(ks[17]),
        "ffn2_pre_g": gain(ks[18]),
        "ffn2_w_gate": dense(ks[19], (DEPTH, D_MODEL, D_FF), D_MODEL),
        "ffn2_w_up": dense(ks[21], (DEPTH, D_MODEL, D_FF), D_MODEL),
        "ffn2_w_down": dense(ks[22], (DEPTH, D_FF, D_MODEL), D_FF),
        "ffn2_post_g": gain(ks[23]),
        "ple_w_proj": dense(ks[24], (DEPTH, PLE_DIM, D_MODEL), PLE_DIM),
        "ple_w_gate": dense(ks[25], (DEPTH, D_MODEL, D_MODEL), D_MODEL),
        "ple_post_g": gain(ks[26]),
    }


def reference(x, p, ffn1_pre_g, ffn1_w_gate, ffn1_w_up, ffn1_w_down, ffn1_post_g,
              mix_pre_g, w_in, rel_bias, conv_w, conv_b, lru_w_a, lru_b_a, lru_w_i,
              lru_b_i, lru_lambda, w_out, mix_post_g, ffn2_pre_g, ffn2_w_gate,
              ffn2_w_up, ffn2_w_down, ffn2_post_g, ple_w_proj, ple_w_gate, ple_post_g):
    B, S, _ = x.shape
    h = x
    for l in range(DEPTH):
        f = swiglu(rms_norm(h, ffn1_pre_g[l]), ffn1_w_gate[l], ffn1_w_up[l], ffn1_w_down[l])
        h = h + 0.5 * rms_norm(f, ffn1_post_g[l])

        u = rms_norm(h, mix_pre_g[l])
        z = u @ w_in[l]
        q, k, v, xr, yg = jnp.split(
            z, [ATT_WIDTH, 2 * ATT_WIDTH, 3 * ATT_WIDTH, 3 * ATT_WIDTH + RNN_WIDTH], axis=-1)
        heads = (B, S, N_ATT_HEADS, HEAD_DIM)
        att = chunked_rel_attention(q.reshape(heads), k.reshape(heads), v.reshape(heads),
                                    rel_bias[l])
        xr = causal_depthwise_conv(xr, conv_w[l], conv_b[l])
        rec = rg_lru(xr, lru_w_a[l], lru_b_a[l], lru_w_i[l], lru_b_i[l], lru_lambda[l])
        rec = rec * jax.nn.gelu(yg)
        mix = jnp.concatenate([att, rec], axis=-1) @ w_out[l]
        h = h + rms_norm(mix, mix_post_g[l])

        f = swiglu(rms_norm(h, ffn2_pre_g[l]), ffn2_w_gate[l], ffn2_w_up[l], ffn2_w_down[l])
        h = h + 0.5 * rms_norm(f, ffn2_post_g[l])

        e = (p[l] @ ple_w_proj[l]) * jax.nn.sigmoid(h @ ple_w_gate[l])
        h = h + rms_norm(e, ple_post_g[l])
    return h
```

```cpp
#include <hip/hip_runtime.h>
#include <cstdio>
#include <cstdint>
namespace pg8 {
#define PG8_LAS __attribute__((address_space(3)))
typedef unsigned short bf16_t;
typedef short bf16x8 __attribute__((ext_vector_type(8)));
typedef float f32x4 __attribute__((ext_vector_type(4)));
typedef unsigned u32x4 __attribute__((ext_vector_type(4)));
constexpr int BM = 256, BK = 64, HALF = 128, HTB = HALF * BK * 2  , STAGE_BYTES = 8 * HTB, NXCD = 8, WGM = 8;

__host__ __device__ __forceinline__ int lds_byte(int r, int c) { const int st = (r >> 4) * 2 + (c >> 5), rr = r & 15, cc = c & 31, ob = rr * 64 + cc * 2; return st * 1024 + (ob ^ (((ob >> 9) & 1) << 5)); }
__host__ __device__ __forceinline__ void stage_rc(int b, int& R, int& C) { const int st = b / 1024, sb = b % 1024, swz = sb ^ (((sb >> 9) & 1) << 5); R = (st >> 1) * 16 + swz / 64; C = (st & 1) * 32 + (swz % 64) / 2; }
__host__ __device__ __forceinline__ int perm32(int rho) { const int n = rho >> 4, i = rho & 15; return 8 * (i >> 2) + 4 * n + (i & 3); }

struct Unit { int pm, pn; };
struct Gemm { const bf16_t* A; const bf16_t* Bt; int M, N, K; };

struct StaticOrder {
    int nM, nN, nwg, G, c;
    __host__ __device__ void init(int M, int N, int G_, int c_) { nM = M / BM; nN = N / BM; nwg = nM * nN; G = G_; c = c_; }
    __host__ __device__ bool next(int i, Unit& u) const {
        const long L = (long)i * G + c; if (L >= nwg) return false;
        int wgid = (int)L; { const int q = nwg / NXCD, r = nwg % NXCD, xcd = wgid % NXCD, off = wgid / NXCD; wgid = (xcd < r ? xcd * (q + 1) : r * (q + 1) + (xcd - r) * q) + off; }
        const int nig = WGM * nN, gid = wgid / nig, fm = gid * WGM, gsz = (nM - fm) < WGM ? (nM - fm) : WGM;
        u.pm = fm + ((wgid % nig) % gsz); u.pn = (wgid % nig) / gsz; return true;
    }
    __device__ __forceinline__ void a_ready(const Unit&) const {}
    __device__ __forceinline__ void done(const Unit&) const {}
};

__device__ __forceinline__ unsigned cvt_pk_bf16(float lo, float hi) { unsigned r; asm volatile("v_cvt_pk_bf16_f32 %0, %1, %2" : "=v"(r) : "v"(lo), "v"(hi)); return r; }
typedef float f32x2 __attribute__((ext_vector_type(2)));

__device__ __forceinline__ float fast_sigmoid(float x) { return __builtin_amdgcn_rcpf(1.0f + __builtin_amdgcn_exp2f(-1.44269504089f * x)); }

struct EpiF32 {
    static constexpr bool PERM = false, AFTER_DRAIN = false;
    float* C; int ldc;
    __device__ __forceinline__ void operator()(const f32x4 (&acc)[2][2][4][2], const Unit& u, int wr, int wc, int fr, int fq) const {
        const int row0 = u.pm * BM + wr * 64 + fr, col0 = u.pn * BM + wc * 32 + 4 * fq;
#pragma unroll
        for (int ai = 0; ai < 2; ++ai)
#pragma unroll
            for (int m = 0; m < 4; ++m) { float* rowp = C + (size_t)(row0 + ai * HALF + m * 16) * ldc + col0;
#pragma unroll
                for (int bj = 0; bj < 2; ++bj)
#pragma unroll
                    for (int n = 0; n < 2; ++n) *(f32x4*)(rowp + bj * HALF + n * 16) = acc[ai][bj][m][n]; }
    }
};
struct EpiPle {
    static constexpr bool PERM = false, AFTER_DRAIN = false;
    const float* EP; float* C; int ldc;
    __device__ __forceinline__ void operator()(const f32x4 (&acc)[2][2][4][2], const Unit& u, int wr, int wc, int fr, int fq) const {
        const int row0 = u.pm * BM + wr * 64 + fr, col0 = u.pn * BM + wc * 32 + 4 * fq;
#pragma unroll
        for (int ai = 0; ai < 2; ++ai)
#pragma unroll
            for (int m = 0; m < 4; ++m) { const size_t off = (size_t)(row0 + ai * HALF + m * 16) * ldc + col0;
#pragma unroll
                for (int bj = 0; bj < 2; ++bj)
#pragma unroll
                    for (int n = 0; n < 2; ++n) { const f32x4 e = *(const f32x4*)(EP + off + bj * HALF + n * 16); const f32x4 a = acc[ai][bj][m][n]; f32x4 o;
                        o[0] = e[0] * fast_sigmoid(a[0]); o[1] = e[1] * fast_sigmoid(a[1]); o[2] = e[2] * fast_sigmoid(a[2]); o[3] = e[3] * fast_sigmoid(a[3]);
                        *(f32x4*)(C + off + bj * HALF + n * 16) = o; }
                asm volatile("" ::: "memory"); }
    }
};
struct EpiSwiGLU {
    static constexpr bool PERM = true, AFTER_DRAIN = false;
    bf16_t* O; int ldc;
    __device__ __forceinline__ void operator()(const f32x4 (&acc)[2][2][4][2], const Unit& u, int wr, int wc, int fr, int fq) const {
        const int row0 = u.pm * BM + wr * 64 + fr, col0 = u.pn * HALF + wc * 32 + 8 * fq;
#pragma unroll
        for (int ai = 0; ai < 2; ++ai)
#pragma unroll
            for (int m = 0; m < 4; ++m) { bf16_t* rowp = O + (size_t)(row0 + ai * HALF + m * 16) * ldc + col0;
                float v[8];
#pragma unroll
                for (int n = 0; n < 2; ++n)
#pragma unroll
                    for (int j = 0; j < 4; ++j) { const float gt = acc[ai][0][m][n][j], up = acc[ai][1][m][n][j]; v[4 * n + j] = gt * fast_sigmoid(gt) * up; }
                u32x4 w; w.x = cvt_pk_bf16(v[0], v[1]); w.y = cvt_pk_bf16(v[2], v[3]); w.z = cvt_pk_bf16(v[4], v[5]); w.w = cvt_pk_bf16(v[6], v[7]);
                *(u32x4*)rowp = w; }
    }
};
struct EpiWin {
    static constexpr bool PERM = true, AFTER_DRAIN = false;
    bf16_t* Q; bf16_t* Kb; bf16_t* VT; bf16_t* XR; bf16_t* YG; float qscale;
    __device__ __forceinline__ void operator()(const f32x4 (&acc)[2][2][4][2], const Unit& u, int wr, int wc, int fr, int fq) const {
        const int sec = u.pn >> 3, colt = (u.pn & 7) * BM;
        const int row0 = u.pm * BM + wr * 64 + fr, col0 = colt + wc * 32 + 8 * fq;
        if (sec == 2) {
            const int b = (u.pm * BM) >> 12;
#pragma unroll
            for (int ai = 0; ai < 2; ++ai)
#pragma unroll
                for (int m = 0; m < 4; ++m) { const int s = (row0 + ai * HALF + m * 16) & 4095;
#pragma unroll
                    for (int bj = 0; bj < 2; ++bj)
#pragma unroll
                        for (int n = 0; n < 2; ++n) { const unsigned p0 = cvt_pk_bf16(acc[ai][bj][m][n][0], acc[ai][bj][m][n][1]), p1 = cvt_pk_bf16(acc[ai][bj][m][n][2], acc[ai][bj][m][n][3]);
                            bf16_t* vp = VT + (size_t)(b * 2048 + col0 + bj * HALF + 4 * n) * 4096 + s;
                            vp[0] = (bf16_t)(p0 & 0xffffu); vp[4096] = (bf16_t)(p0 >> 16); vp[2 * 4096] = (bf16_t)(p1 & 0xffffu); vp[3 * 4096] = (bf16_t)(p1 >> 16); } }
            return;
        }
        bf16_t* base = sec == 0 ? Q : sec == 1 ? Kb : sec == 3 ? XR : YG; const float sc = sec == 0 ? qscale : 1.0f;
#pragma unroll
        for (int ai = 0; ai < 2; ++ai)
#pragma unroll
            for (int m = 0; m < 4; ++m) { bf16_t* rowp = base + (size_t)(row0 + ai * HALF + m * 16) * 2048 + col0;
#pragma unroll
                for (int bj = 0; bj < 2; ++bj) { const f32x4 v0 = acc[ai][bj][m][0] * sc, v1 = acc[ai][bj][m][1] * sc;
                    u32x4 w; w.x = cvt_pk_bf16(v0[0], v0[1]); w.y = cvt_pk_bf16(v0[2], v0[3]); w.z = cvt_pk_bf16(v1[0], v1[1]); w.w = cvt_pk_bf16(v1[2], v1[3]);
                    *(u32x4*)(rowp + bj * HALF) = w; } }
    }
};
template <class Epi, class Sched, bool ALIGN_EPI = false, bool SP2 = false>
__device__ __forceinline__ void gemm_phase(PG8_LAS unsigned char* lds, const Gemm g, const Sched& S, const Epi& E) {
    const int tid = threadIdx.x, wid = __builtin_amdgcn_readfirstlane(tid >> 6), lane = tid & 63, wr = wid >> 2, wc = wid & 3, fr = lane & 15, fq = lane >> 4;
    const int K = g.K, nt = K / BK;
    unsigned voffA[2], voffB[2];
#pragma unroll
    for (int i = 0; i < 2; ++i) { int R, C; stage_rc(tid * 16 + i * 8192, R, C); const int Rb = Epi::PERM ? ((R & ~31) + perm32(R & 31)) : R;
        voffA[i] = (unsigned)(R * K + C) * 2u; voffB[i] = (unsigned)(Rb * K + C) * 2u; }
    const size_t kstep = (size_t)(BK * 2);
    const size_t hstep = (size_t)HALF * K * 2;
    const size_t tstep = 2 * hstep;
    const unsigned ldsw = (unsigned)wid * 1024u;
    const int aoff = lds_byte(wr * 64 + fr, fq * 8), boff = lds_byte(wc * 32 + fr, fq * 8);
#define PG8_SA(b, h) (((b) * 2 + (h)) * HTB)
#define PG8_SB(b, h) ((4 + (b) * 2 + (h)) * HTB)
#define PG8_STAGE(bufoff, gbase, voff) do { _Pragma("unroll") for (int _i = 0; _i < 2; ++_i) \
        __builtin_amdgcn_global_load_lds((const unsigned*)((const char*)(gbase) + (voff)[_i]), (PG8_LAS unsigned*)(lds + (bufoff) + ldsw + _i * 8192), 16, 0, 0); } while (0)
#define PG8_LDA(dst, b, h) do { _Pragma("unroll") for (int m = 0; m < 4; ++m) _Pragma("unroll") for (int k = 0; k < 2; ++k) dst[m][k] = *(const PG8_LAS bf16x8*)(lds + PG8_SA(b, h) + aoff + m * 2048 + k * 1024); } while (0)
#define PG8_LDB(dst, b, h) do { _Pragma("unroll") for (int n = 0; n < 2; ++n) _Pragma("unroll") for (int k = 0; k < 2; ++k) dst[n][k] = *(const PG8_LAS bf16x8*)(lds + PG8_SB(b, h) + boff + n * 2048 + k * 1024); } while (0)
#define PG8_MMA(ai, bj, At, Bt) do { __builtin_amdgcn_s_setprio(1); _Pragma("unroll") for (int m = 0; m < 4; ++m) _Pragma("unroll") for (int n = 0; n < 2; ++n) _Pragma("unroll") for (int k = 0; k < 2; ++k) \
        acc[ai][bj][m][n] = __builtin_amdgcn_mfma_f32_16x16x32_bf16(Bt[n][k], At[m][k], acc[ai][bj][m][n], 0, 0, 0); __builtin_amdgcn_s_setprio(0); } while (0)
#define PG8_WAIT_V(n) asm volatile("s_waitcnt vmcnt(" #n ")" ::: "memory")
#define PG8_WAIT_L(n) asm volatile("s_waitcnt lgkmcnt(" #n ")" ::: "memory")
#define PG8_BAR __builtin_amdgcn_s_barrier()
#define PG8_SCHED __builtin_amdgcn_sched_barrier(0)
    Unit cur, nxt; int ui = 0;
    if (!S.next(0, cur)) return;
    f32x4 acc[2][2][4][2];
#pragma unroll
    for (int a = 0; a < 2; ++a)
#pragma unroll
        for (int b = 0; b < 2; ++b)
#pragma unroll
            for (int m = 0; m < 4; ++m)
#pragma unroll
                for (int n = 0; n < 2; ++n) acc[a][b][m][n] = (f32x4){0.f, 0.f, 0.f, 0.f};
    bf16x8 At[4][2], B0[2][2], B1[2][2];
    const char* cA = (const char*)g.A + (size_t)cur.pm * tstep; const char* cB = (const char*)g.Bt + (size_t)cur.pn * tstep;
    S.a_ready(cur);
    if constexpr (SP2) {
        PG8_STAGE(PG8_SB(0, 0), cB, voffB); PG8_STAGE(PG8_SB(0, 1), cB + hstep, voffB); PG8_STAGE(PG8_SA(0, 0), cA, voffA); PG8_STAGE(PG8_SA(0, 1), cA + hstep, voffA);
        if (wr == 1) PG8_BAR;
        PG8_WAIT_V(2); PG8_BAR;
        PG8_STAGE(PG8_SB(1, 0), cB + kstep, voffB); PG8_STAGE(PG8_SA(1, 0), cA + kstep, voffA); PG8_STAGE(PG8_SB(1, 1), cB + hstep + kstep, voffB);
        PG8_WAIT_V(6); PG8_BAR;
    } else {
        PG8_STAGE(PG8_SB(0, 0), cB, voffB); PG8_STAGE(PG8_SA(0, 0), cA, voffA); PG8_STAGE(PG8_SB(0, 1), cB + hstep, voffB); PG8_STAGE(PG8_SA(0, 1), cA + hstep, voffA);
        if (wr == 1) PG8_BAR;
        PG8_WAIT_V(4); PG8_BAR;
        PG8_STAGE(PG8_SB(1, 0), cB + kstep, voffB); PG8_STAGE(PG8_SA(1, 0), cA + kstep, voffA); PG8_STAGE(PG8_SB(1, 1), cB + hstep + kstep, voffB);
        PG8_WAIT_V(6); PG8_BAR;
    }
    for (;;) {
        const bool has_next = S.next(ui + 1, nxt);
        const char* nA = has_next ? (const char*)g.A + (size_t)nxt.pm * tstep : cA; const char* nB = has_next ? (const char*)g.Bt + (size_t)nxt.pn * tstep : cB;
        for (int t = 0; t < nt; t += 2) {
            const bool last = (t == nt - 2);
            const char* a1 = cA + (size_t)(t + 1) * kstep;
            const char* a2 = last ? nA : cA + (size_t)(t + 2) * kstep; const char* b2 = last ? nB : cB + (size_t)(t + 2) * kstep;
            const char* a3 = a2 + kstep; const char* b3 = b2 + kstep;
            if (last && has_next) S.a_ready(nxt);
            if constexpr (SP2) {
            PG8_LDB(B0, 0, 0); PG8_LDB(B1, 0, 1); PG8_SCHED; PG8_LDA(At, 0, 0); PG8_STAGE(PG8_SA(1, 1), a1 + hstep, voffA);
            PG8_WAIT_V(8); PG8_WAIT_L(0); PG8_BAR; PG8_MMA(0, 0, At, B0); PG8_MMA(0, 1, At, B1); PG8_BAR; PG8_SCHED;
            PG8_LDA(At, 0, 1); PG8_STAGE(PG8_SB(0, 0), b2, voffB); PG8_STAGE(PG8_SB(0, 1), b2 + hstep, voffB); PG8_STAGE(PG8_SA(0, 0), a2, voffA);
            PG8_WAIT_V(8); PG8_WAIT_L(0); PG8_BAR; PG8_MMA(1, 0, At, B0); PG8_MMA(1, 1, At, B1); PG8_BAR; PG8_SCHED;
            PG8_LDB(B0, 1, 0); PG8_LDB(B1, 1, 1); PG8_SCHED; PG8_LDA(At, 1, 0); PG8_STAGE(PG8_SA(0, 1), a2 + hstep, voffA);
            PG8_WAIT_V(8); PG8_WAIT_L(0); PG8_BAR; PG8_MMA(0, 0, At, B0); PG8_MMA(0, 1, At, B1); PG8_BAR; PG8_SCHED;
            PG8_LDA(At, 1, 1); PG8_STAGE(PG8_SB(1, 0), b3, voffB); PG8_STAGE(PG8_SB(1, 1), b3 + hstep, voffB); PG8_STAGE(PG8_SA(1, 0), a3, voffA);
            PG8_WAIT_V(8); PG8_WAIT_L(0); PG8_BAR; PG8_MMA(1, 0, At, B0); PG8_MMA(1, 1, At, B1); PG8_BAR; PG8_SCHED;
            } else {
            PG8_LDB(B0, 0, 0); PG8_SCHED; PG8_LDA(At, 0, 0); PG8_STAGE(PG8_SA(1, 1), a1 + hstep, voffA);
            PG8_WAIT_L(8); PG8_BAR; PG8_WAIT_L(0); PG8_MMA(0, 0, At, B0); PG8_BAR; PG8_SCHED;
            PG8_LDB(B1, 0, 1); PG8_STAGE(PG8_SB(0, 0), b2, voffB);
            PG8_BAR; PG8_WAIT_L(0); PG8_MMA(0, 1, At, B1); PG8_BAR;
            PG8_LDA(At, 0, 1); PG8_STAGE(PG8_SA(0, 0), a2, voffA);
            PG8_BAR; PG8_WAIT_L(0); PG8_MMA(1, 0, At, B0); PG8_BAR; PG8_SCHED;
            PG8_STAGE(PG8_SB(0, 1), b2 + hstep, voffB);
            PG8_WAIT_V(6); PG8_BAR; PG8_MMA(1, 1, At, B1); PG8_BAR;
            PG8_LDB(B0, 1, 0); PG8_SCHED; PG8_LDA(At, 1, 0); PG8_STAGE(PG8_SA(0, 1), a2 + hstep, voffA);
            PG8_WAIT_L(8); PG8_BAR; PG8_WAIT_L(0); PG8_MMA(0, 0, At, B0); PG8_BAR; PG8_SCHED;
            PG8_LDB(B1, 1, 1); PG8_STAGE(PG8_SB(1, 0), b3, voffB);
            PG8_BAR; PG8_WAIT_L(0); PG8_MMA(0, 1, At, B1); PG8_BAR;
            PG8_LDA(At, 1, 1); PG8_STAGE(PG8_SA(1, 0), a3, voffA);
            PG8_BAR; PG8_WAIT_L(0); PG8_MMA(1, 0, At, B0); PG8_BAR; PG8_SCHED;
            PG8_STAGE(PG8_SB(1, 1), b3 + hstep, voffB);
            PG8_WAIT_V(6); PG8_BAR; PG8_MMA(1, 1, At, B1); PG8_BAR;
            }
        }
        if constexpr (ALIGN_EPI) { if (wr == 0) PG8_BAR; }
        if constexpr (!Epi::AFTER_DRAIN) { E(acc, cur, wr, wc, fr, fq); S.done(cur); }
        if (!has_next) break;
#pragma unroll
        for (int a = 0; a < 2; ++a)
#pragma unroll
            for (int b = 0; b < 2; ++b)
#pragma unroll
                for (int m = 0; m < 4; ++m)
#pragma unroll
                    for (int n = 0; n < 2; ++n) acc[a][b][m][n] = (f32x4){0.f, 0.f, 0.f, 0.f};
        cur = nxt; cA = nA; cB = nB; ++ui;
        if constexpr (ALIGN_EPI) { if (wr == 1) PG8_BAR; }
    }
    PG8_WAIT_V(0);
    if constexpr (!ALIGN_EPI) { if (wr == 0) PG8_BAR; }
    PG8_BAR;
    if constexpr (Epi::AFTER_DRAIN) { E.fused(acc, cur, wr, wc, fr, fq, lds, wid, lane); S.done(cur); }
#undef PG8_SA
#undef PG8_SB
#undef PG8_STAGE
#undef PG8_LDA
#undef PG8_LDB
#undef PG8_MMA
#undef PG8_WAIT_V
#undef PG8_WAIT_L
#undef PG8_BAR
#undef PG8_SCHED
}
}

#ifndef MK_PER_PHASE
#define MK_PER_PHASE 1
#endif
#ifndef MK_PH_HI
#define MK_PH_HI 14
#endif
#ifndef MK_PHASE_MASK
#define MK_PHASE_MASK 0x3fff
#endif
constexpr int NWAVES = 8;
constexpr int NPHASE = 14;

constexpr int BATCH = 2, SEQ = 4096, D = 4096, M = BATCH * SEQ, FF = 11008, NIN = 10240, AW = 2048, RW = 2048, PLE = 256, NREL = 257;
constexpr float EPS = 1e-6f, LOG2E = 1.4426950408889634f;

constexpr size_t MiB = 1u << 20;
constexpr size_t WS_CTL = 0, CTL_ZERO_BYTES = 1 * MiB;
constexpr size_t WS_AGG = 1 * MiB;
constexpr size_t WS_LWA = 2 * MiB, WS_LWI = 2 * MiB + 512 * 1024;
constexpr size_t WS_PB = 3 * MiB;
constexpr size_t WS_WPP = 7 * MiB;
constexpr size_t WS_WOUT = 9 * MiB, WS_WPG = 41 * MiB;
constexpr size_t WS_WIN = 73 * MiB;
constexpr size_t WS_WG1 = 153 * MiB, WS_WD1 = 325 * MiB;
constexpr size_t WS_WG2 = 411 * MiB, WS_WD2 = 583 * MiB;
constexpr size_t WS_ABUF = 669 * MiB;
constexpr size_t WS_ACT = 733 * MiB;
constexpr size_t WS_Q = WS_ACT, WS_K = WS_ACT + 32 * MiB, WS_VT = WS_ACT + 64 * MiB, WS_XR = WS_ACT + 96 * MiB, WS_YG = WS_ACT + 128 * MiB;
constexpr size_t WS_MIX = 905 * MiB;
constexpr size_t WS_F = 969 * MiB;
constexpr size_t WS_EP = 1097 * MiB;
constexpr size_t WS_END = 1225 * MiB;
static_assert(WS_ACT + (size_t)M * FF * 2 <= WS_MIX && WS_YG + 32 * MiB <= WS_MIX && WS_WD2 + (size_t)D * FF * 2 <= WS_ABUF && WS_WG1 + (size_t)2 * FF * D * 2 <= WS_WD1, "d_ws map");
constexpr int CW_BAR = 4096;

constexpr int RING_BYTES = 143360;
constexpr int LDSCTL_OFF = RING_BYTES, MISC_OFF = LDSCTL_OFF + 320;
constexpr int LDS_BYTES = 147456;
constexpr int ATT_RS = 132;
constexpr int ATT_SMAX_OFF = 8 * 32 * ATT_RS * 4;
static_assert(ATT_SMAX_OFF + 1024 + 1024 + 1040 <= RING_BYTES, "attention LDS");
constexpr int RNN_XCB_RS = 136, RNN_XCF_RS = 132;
constexpr int RNN_XCF_OFF = 64 * RNN_XCB_RS * 2;
constexpr int RNN_BUF = RNN_XCF_OFF + 64 * RNN_XCF_RS * 4;
static_assert(2 * RNN_BUF <= RING_BYTES, "rnn LDS");

#define GAS __attribute__((address_space(1)))
#define LAS __attribute__((address_space(3)))
typedef unsigned short bf16;
typedef unsigned v4u __attribute__((ext_vector_type(4)));
typedef unsigned v2u __attribute__((ext_vector_type(2)));
typedef float f32x4 __attribute__((ext_vector_type(4)));
typedef short bf16x8 __attribute__((ext_vector_type(8)));
typedef GAS unsigned gu32;
#define RLX_AGENT __ATOMIC_RELAXED, __HIP_MEMORY_SCOPE_AGENT
#define LDS_WAIT() asm volatile("s_waitcnt lgkmcnt(0)" ::: "memory")
#define VM_WAIT() asm volatile("s_waitcnt vmcnt(0)" ::: "memory")
__device__ __forceinline__ unsigned pk2(float lo, float hi) { return pg8::cvt_pk_bf16(lo, hi); }
__device__ __forceinline__ float bf_lo(unsigned u) { return __builtin_bit_cast(float, u << 16); }
__device__ __forceinline__ float bf_hi(unsigned u) { return __builtin_bit_cast(float, u & 0xffff0000u); }
__device__ __forceinline__ float wave_sum(float v) {
#pragma unroll
    for (int o = 1; o < 64; o <<= 1) v += __shfl_xor(v, o);
    return v;
}
#define XB_TMO      128
#define XB_XCNT(j)  (256  + 64 * (j))
#define XB_XSUB(j)  (1280 + 64 * (j))
#define XB_XGEN(j)  (2304 + 64 * (j))
#define XB_TOP      3328
#define XB_TOPGEN   3392
#define XCD_BAR_WORDS 3456
#define XB_SPIN_CAP (1u << 18)

__device__ __forceinline__ unsigned xb_ld(unsigned* p)              { return __hip_atomic_load(p, __ATOMIC_RELAXED, __HIP_MEMORY_SCOPE_AGENT); }
__device__ __forceinline__ unsigned xb_add(unsigned* p, unsigned v) { return __hip_atomic_fetch_add(p, v, __ATOMIC_RELAXED, __HIP_MEMORY_SCOPE_AGENT); }
__device__ __forceinline__ unsigned xb_xcc_id() { return (unsigned)__builtin_amdgcn_s_getreg((3 << 11) | 20) & 0xFu; }
#define XB_SPIN(cond, bar) do { unsigned _sp = 0; while (cond) { __builtin_amdgcn_s_sleep(1); \
    if ((++_sp & 255u) == 0u) { if (xb_ld(&(bar)[XB_TMO])) break; if (_sp > XB_SPIN_CAP) { atomicAdd(&(bar)[XB_TMO], 1u); break; } } } } while (0)

struct XcdBarrier {
    unsigned* bar; unsigned x;
    volatile LAS unsigned* st;
};

__device__ __forceinline__ XcdBarrier xcd_barrier_post(unsigned* bar, volatile LAS unsigned* st) {
    XcdBarrier b; b.bar = bar; b.x = xb_xcc_id(); b.st = st;
    if (threadIdx.x == 0) (void)xb_add(&bar[XB_XCNT(b.x)], 1u);
    return b;
}
__device__ __forceinline__ void xcd_barrier_complete(unsigned* bar, unsigned x, unsigned& nloc, unsigned& nx) {
    const unsigned G = gridDim.x * gridDim.y * gridDim.z;
    unsigned sum, cnt, mine, sp = 0u;
    for (;;) {
        sum = 0u; cnt = 0u; mine = 0u;
#pragma unroll
        for (unsigned j = 0; j < 16; ++j) { const unsigned c = xb_ld(&bar[XB_XCNT(j)]); sum += c; cnt += (c > 0u) ? 1u : 0u; mine = (j == x) ? c : mine; }
        if (sum == G) break;
        __builtin_amdgcn_s_sleep(1);
        if ((++sp & 255u) == 0u) { if (xb_ld(&bar[XB_TMO])) break; if (sp > XB_SPIN_CAP) { atomicAdd(&bar[XB_TMO], 1u); break; } }
    }
    nloc = mine > 0u ? mine : 1u; nx = cnt > 0u ? cnt : 1u;
}

__device__ __forceinline__ void xcd_barrier(const XcdBarrier& b) {
    asm volatile("s_waitcnt vmcnt(0)" ::: "memory");
    __syncthreads();
    if (threadIdx.x == 0) {
        unsigned* bar = b.bar;
        __builtin_amdgcn_s_waitcnt(0);
        unsigned nloc = b.st[0], nx = b.st[1];
        if (nloc == 0u) { xcd_barrier_complete(bar, b.x, nloc, nx); b.st[0] = nloc; b.st[1] = nx; }
        const unsigned old = xb_add(&bar[XB_XSUB(b.x)], 1u);
        const unsigned gen = old / nloc;
        if (old + 1u == (gen + 1u) * nloc) {
            __builtin_amdgcn_fence(__ATOMIC_RELEASE, "agent");
            asm volatile("s_waitcnt vmcnt(0)" ::: "memory");
            const unsigned og = xb_add(&bar[XB_TOP], 1u);
            const unsigned tg = og / nx;
            if (og + 1u == (tg + 1u) * nx) xb_add(&bar[XB_TOPGEN], 1u);
            else XB_SPIN(xb_ld(&bar[XB_TOPGEN]) == tg, bar);
            __builtin_amdgcn_fence(__ATOMIC_ACQUIRE, "agent");
            xb_add(&bar[XB_XGEN(b.x)], 1u);
            asm volatile("s_waitcnt vmcnt(0)" ::: "memory");
        } else {
            XB_SPIN(xb_ld(&bar[XB_XGEN(b.x)]) == gen, bar);
            __builtin_amdgcn_fence(__ATOMIC_ACQUIRE, "agent");
            asm volatile("s_waitcnt vmcnt(0)" ::: "memory");
        }
    }
    __syncthreads();
}

__device__ __forceinline__ void tr_item(const float* __restrict__ W, int N, bf16* __restrict__ WT, int K, int k0, int n0, int orow0, LAS float* scr, int lane) {
    const int kr = lane >> 4, nq = lane & 15;
    f32x4 v[16];
#pragma unroll
    for (int i = 0; i < 16; ++i) v[i] = *(const GAS f32x4*)(W + (size_t)(k0 + 4 * i + kr) * N + n0 + 4 * nq);
#pragma unroll
    for (int i = 0; i < 16; ++i) { const int k = 4 * i + kr; *(LAS f32x4*)(scr + k * 64 + 4 * (nq ^ ((k >> 3) & 7))) = v[i]; }
    LDS_WAIT(); asm volatile("" ::: "memory");
    const int c = lane & 7, nn = lane >> 3;
#pragma unroll
    for (int j = 0; j < 8; ++j) { const int n = nn + 8 * j; const LAS float* s = scr + (8 * c) * 64 + 4 * ((n >> 2) ^ c) + (n & 3);
        v4u o; o.x = pk2(s[0 * 64], s[1 * 64]); o.y = pk2(s[2 * 64], s[3 * 64]); o.z = pk2(s[4 * 64], s[5 * 64]); o.w = pk2(s[6 * 64], s[7 * 64]);
        *(GAS v4u*)(WT + (size_t)(orow0 + n) * K + k0 + 8 * c) = o; }
    LDS_WAIT(); asm volatile("" ::: "memory");
}

template <bool HAS_F, bool NORM_A, bool WRITE_H, bool WRITE_A>
__device__ __forceinline__ void row_phase(LAS unsigned char* lds, const float* f, const float* hin, const float* __restrict__ gpost, float alpha, const float* __restrict__ gpre, float* hout, bf16* aout, int gw, int NGW, int lane, int tid) {
    LAS f32x4* gpo = (LAS f32x4*)lds; LAS f32x4* gpr = (LAS f32x4*)(lds + 16384);
    __syncthreads();
    if (HAS_F) for (int q = tid; q < D / 4; q += NWAVES * 64) gpo[q] = ((const GAS f32x4*)gpost)[q];
    if (WRITE_A && NORM_A) for (int q = tid; q < D / 4; q += NWAVES * 64) gpr[q] = ((const GAS f32x4*)gpre)[q];
    __syncthreads();
    for (int m = gw; m < M; m += NGW) {
        const GAS f32x4* hr = (const GAS f32x4*)(hin + (size_t)m * D) + lane;
        f32x4 h[16];
        if (HAS_F) {
            const GAS f32x4* fr = (const GAS f32x4*)(f + (size_t)m * D) + lane;
            f32x4 fv[16]; float ss = 0.f;
#pragma unroll
            for (int j = 0; j < 16; ++j) { fv[j] = fr[64 * j]; ss += (fv[j].x * fv[j].x + fv[j].y * fv[j].y) + (fv[j].z * fv[j].z + fv[j].w * fv[j].w); }
            const float rs = alpha * __builtin_amdgcn_rsqf(wave_sum(ss) * (1.0f / D) + EPS);
#pragma unroll
            for (int jj = 0; jj < 4; ++jj) {
#pragma unroll
                for (int j = 4 * jj; j < 4 * jj + 4; ++j) { const f32x4 gp = gpo[lane + 64 * j]; h[j] = hr[64 * j] + fv[j] * gp * rs; }
                asm volatile("" ::: "memory"); }
        } else {
#pragma unroll
            for (int j = 0; j < 16; ++j) h[j] = hr[64 * j];
        }
        if (WRITE_H) { GAS f32x4* ho = (GAS f32x4*)(hout + (size_t)m * D) + lane;
#pragma unroll
            for (int j = 0; j < 16; ++j) ho[64 * j] = h[j]; }
        if (WRITE_A) {
            float rs2 = 1.0f;
            if (NORM_A) { float s2 = 0.f;
#pragma unroll
                for (int j = 0; j < 16; ++j) s2 += (h[j].x * h[j].x + h[j].y * h[j].y) + (h[j].z * h[j].z + h[j].w * h[j].w);
                rs2 = __builtin_amdgcn_rsqf(wave_sum(s2) * (1.0f / D) + EPS); }
            GAS v2u* ao = (GAS v2u*)(aout + (size_t)m * D) + lane;
#pragma unroll
            for (int jj = 0; jj < 4; ++jj) {
#pragma unroll
                for (int j = 4 * jj; j < 4 * jj + 4; ++j) { f32x4 v = h[j] * rs2; if (NORM_A) v = v * gpr[lane + 64 * j];
                    v2u o; o.x = pk2(v.x, v.y); o.y = pk2(v.z, v.w); ao[64 * j] = o; }
                asm volatile("" ::: "memory"); }
        }
    }
}

__device__ __forceinline__ void attn_unit(LAS unsigned char* lds, const bf16* __restrict__ Q, const bf16* __restrict__ Kb, const bf16* __restrict__ VT, const float* __restrict__ relb, bf16* __restrict__ MIX,
                                          int b, int h, int c, int tid, int w, int lane) {
    const int i = lane & 15, g = lane >> 4, rq2 = w & 1, kq = w >> 1;
    LAS float* Opart = (LAS float*)lds;
    LAS float* smax = (LAS float*)(lds + ATT_SMAX_OFF);
    LAS float* ssum = smax + 256;
    LAS float* btab = ssum + 256;
    if (tid < NREL) btab[tid] = relb[h * NREL + tid] * LOG2E;
    const int qrow0 = b * SEQ + 64 * c + 32 * rq2;
    bf16x8 qf[2][4];
#pragma unroll
    for (int qi = 0; qi < 2; ++qi)
#pragma unroll
        for (int kk = 0; kk < 4; ++kk) qf[qi][kk] = *(const GAS bf16x8*)(Q + (size_t)(qrow0 + 16 * qi + i) * AW + h * 128 + 32 * kk + 8 * g);
    const int kbase = 64 * c - 512 + 144 * kq;
    f32x4 s[9][2];
#pragma unroll
    for (int t = 0; t < 9; ++t) {
        s[t][0] = (f32x4){0.f, 0.f, 0.f, 0.f}; s[t][1] = (f32x4){0.f, 0.f, 0.f, 0.f};
        const int kpos = kbase + 16 * t;
        if (kpos >= 0) {
            const bf16* Kp = Kb + (size_t)(b * SEQ + kpos + i) * AW + h * 128 + 8 * g;
#pragma unroll
            for (int kk = 0; kk < 4; ++kk) { const bf16x8 kf = *(const GAS bf16x8*)(Kp + 32 * kk);
                s[t][0] = __builtin_amdgcn_mfma_f32_16x16x32_bf16(kf, qf[0][kk], s[t][0], 0, 0, 0);
                s[t][1] = __builtin_amdgcn_mfma_f32_16x16x32_bf16(kf, qf[1][kk], s[t][1], 0, 0, 0); }
        }
    }
    __syncthreads();
    const float NEG = -__builtin_huge_valf();
    float mx[2] = {NEG, NEG};
#pragma unroll
    for (int t = 0; t < 9; ++t) { const bool val = kbase + 16 * t >= 0;
#pragma unroll
        for (int qi = 0; qi < 2; ++qi)
#pragma unroll
            for (int j = 0; j < 4; ++j) { int rel = (32 * rq2 + 16 * qi + i) - (-512 + 144 * kq + 16 * t + 4 * g + j); rel = (rel > 128 ? 128 : (rel < -128 ? -128 : rel)) + 128;
                const float v = val ? s[t][qi][j] + btab[rel] : NEG; s[t][qi][j] = v; mx[qi] = fmaxf(mx[qi], v); } }
#pragma unroll
    for (int qi = 0; qi < 2; ++qi) { mx[qi] = fmaxf(mx[qi], __shfl_xor(mx[qi], 16)); mx[qi] = fmaxf(mx[qi], __shfl_xor(mx[qi], 32)); }
    if (g == 0) { smax[w * 32 + i] = mx[0]; smax[w * 32 + 16 + i] = mx[1]; }
    __syncthreads();
    float ls[2]; unsigned pk[9][2][2];
#pragma unroll
    for (int qi = 0; qi < 2; ++qi) { float mm = smax[rq2 * 32 + 16 * qi + i];
#pragma unroll
        for (int k2 = 1; k2 < 4; ++k2) mm = fmaxf(mm, smax[(2 * k2 + rq2) * 32 + 16 * qi + i]);
        float l = 0.f;
#pragma unroll
        for (int t = 0; t < 9; ++t) { const float p0 = __builtin_amdgcn_exp2f(s[t][qi][0] - mm), p1 = __builtin_amdgcn_exp2f(s[t][qi][1] - mm), p2 = __builtin_amdgcn_exp2f(s[t][qi][2] - mm), p3 = __builtin_amdgcn_exp2f(s[t][qi][3] - mm);
            l += (p0 + p1) + (p2 + p3); pk[t][qi][0] = pk2(p0, p1); pk[t][qi][1] = pk2(p2, p3); }
        l += __shfl_xor(l, 16); l += __shfl_xor(l, 32); ls[qi] = l; }
    if (g == 0) { ssum[w * 32 + i] = ls[0]; ssum[w * 32 + 16 + i] = ls[1]; }
    f32x4 o[8][2];
#pragma unroll
    for (int dt = 0; dt < 8; ++dt) { o[dt][0] = (f32x4){0.f, 0.f, 0.f, 0.f}; o[dt][1] = (f32x4){0.f, 0.f, 0.f, 0.f}; }
    const bf16* vrow = VT + (size_t)(b * AW + h * 128 + i) * SEQ;
#pragma unroll
    for (int pr = 0; pr < 5; ++pr) {
        const int kp0 = kbase + 32 * pr, kp1 = kp0 + 16;
        if ((pr < 4 ? kp1 : kp0) >= 0) {
            const int c0 = (kp0 > 0 ? kp0 : 0) + 4 * g, c1 = pr < 4 ? kp1 + 4 * g : c0;
            v4u pb[2];
#pragma unroll
            for (int qi = 0; qi < 2; ++qi) { pb[qi].x = pk[2 * pr][qi][0]; pb[qi].y = pk[2 * pr][qi][1]; pb[qi].z = pr < 4 ? pk[pr < 4 ? 2 * pr + 1 : 0][qi][0] : 0u; pb[qi].w = pr < 4 ? pk[pr < 4 ? 2 * pr + 1 : 0][qi][1] : 0u; }
#pragma unroll
            for (int dt = 0; dt < 8; ++dt) { const bf16* vp = vrow + (size_t)(16 * dt) * SEQ;
                const v2u v0 = *(const GAS v2u*)(vp + c0), v1 = *(const GAS v2u*)(vp + c1);
                const v4u av = {v0.x, v0.y, v1.x, v1.y}; const bf16x8 af = __builtin_bit_cast(bf16x8, av);
                o[dt][0] = __builtin_amdgcn_mfma_f32_16x16x32_bf16(af, __builtin_bit_cast(bf16x8, pb[0]), o[dt][0], 0, 0, 0);
                o[dt][1] = __builtin_amdgcn_mfma_f32_16x16x32_bf16(af, __builtin_bit_cast(bf16x8, pb[1]), o[dt][1], 0, 0, 0); }
        }
    }
#pragma unroll
    for (int dt = 0; dt < 8; ++dt)
#pragma unroll
        for (int qi = 0; qi < 2; ++qi) *(LAS f32x4*)(Opart + (w * 32 + 16 * qi + i) * ATT_RS + 16 * dt + 4 * g) = o[dt][qi];
    __syncthreads();
    { const int q = lane & 31, d0 = 32 * kq + 16 * (lane >> 5);
      f32x4 a[4] = {(f32x4){0.f, 0.f, 0.f, 0.f}, (f32x4){0.f, 0.f, 0.f, 0.f}, (f32x4){0.f, 0.f, 0.f, 0.f}, (f32x4){0.f, 0.f, 0.f, 0.f}}; float l = 0.f;
#pragma unroll
      for (int k2 = 0; k2 < 4; ++k2) { const int w2 = 2 * k2 + rq2; l += ssum[w2 * 32 + q];
#pragma unroll
          for (int e = 0; e < 4; ++e) a[e] += *(const LAS f32x4*)(Opart + (w2 * 32 + q) * ATT_RS + d0 + 4 * e); }
      const float inv = 1.0f / l;
      v4u o0, o1; o0.x = pk2(a[0].x * inv, a[0].y * inv); o0.y = pk2(a[0].z * inv, a[0].w * inv); o0.z = pk2(a[1].x * inv, a[1].y * inv); o0.w = pk2(a[1].z * inv, a[1].w * inv);
      o1.x = pk2(a[2].x * inv, a[2].y * inv); o1.y = pk2(a[2].z * inv, a[2].w * inv); o1.z = pk2(a[3].x * inv, a[3].y * inv); o1.w = pk2(a[3].z * inv, a[3].w * inv);
      GAS v4u* op = (GAS v4u*)(MIX + (size_t)(qrow0 + q) * D + h * 128 + d0); op[0] = o0; op[1] = o1; }
}

template <bool FINAL>
__device__ __forceinline__ void rnn_group(LAS unsigned char* lds, const bf16* __restrict__ XR, const bf16* __restrict__ YG, const float* __restrict__ conv_w, const float* __restrict__ conv_b,
                                          const bf16* __restrict__ LWA, const bf16* __restrict__ LWI, const float* __restrict__ b_a, const float* __restrict__ b_i, const float* __restrict__ lam,
                                          float2* AGG, bf16* __restrict__ MIX, int b, int n, int kg, int tid, int w, int lane) {
    const int i = lane & 15, g = lane >> 4, chl = 16 * w + i, ch = 128 * n + chl;
    const float ba = b_a[ch], bi = b_i[ch];
    const float sp = 8.0f * LOG2E * log1pf(expf(-lam[ch]));
    bf16x8 wa[4], wi[4];
#pragma unroll
    for (int kk = 0; kk < 4; ++kk) { wa[kk] = *(const GAS bf16x8*)(LWA + (size_t)(n * 128 + chl) * 128 + 32 * kk + 8 * g); wi[kk] = *(const GAS bf16x8*)(LWI + (size_t)(n * 128 + chl) * 128 + 32 * kk + 8 * g); }
    const int cg = tid & 15, tp = tid >> 4, cch = 128 * n + 8 * cg;
    float cw[4][8], cb[8];
#pragma unroll
    for (int j = 0; j < 4; ++j) { const f32x4 a0 = *(const GAS f32x4*)(conv_w + j * RW + cch), a1 = *(const GAS f32x4*)(conv_w + j * RW + cch + 4);
        cw[j][0] = a0.x; cw[j][1] = a0.y; cw[j][2] = a0.z; cw[j][3] = a0.w; cw[j][4] = a1.x; cw[j][5] = a1.y; cw[j][6] = a1.z; cw[j][7] = a1.w; }
    { const f32x4 a0 = *(const GAS f32x4*)(conv_b + cch), a1 = *(const GAS f32x4*)(conv_b + cch + 4); cb[0] = a0.x; cb[1] = a0.y; cb[2] = a0.z; cb[3] = a0.w; cb[4] = a1.x; cb[5] = a1.y; cb[6] = a1.z; cb[7] = a1.w; }
    float hc = 0.f, Atot = 1.f;
    if (FINAL) for (int k2 = 0; k2 < kg; ++k2) { const float2 ab = AGG[((b * 16 + n) * 8 + k2) * 128 + chl]; hc = ab.x * hc + ab.y; }
    for (int k = 0; k < 8; ++k) {
        const int t0 = 512 * kg + 64 * k;
        LAS unsigned char* xcb = lds + (k & 1) * RNN_BUF; LAS float* xcf = (LAS float*)(xcb + RNN_XCF_OFF);
        float x[5][8];
#pragma unroll
        for (int r = 0; r < 5; ++r) { const int t = t0 + 2 * tp - 3 + r;
            v4u v = {0u, 0u, 0u, 0u}; if (t >= 0) v = *(const GAS v4u*)(XR + (size_t)(b * SEQ + t) * RW + cch);
            x[r][0] = bf_lo(v.x); x[r][1] = bf_hi(v.x); x[r][2] = bf_lo(v.y); x[r][3] = bf_hi(v.y); x[r][4] = bf_lo(v.z); x[r][5] = bf_hi(v.z); x[r][6] = bf_lo(v.w); x[r][7] = bf_hi(v.w); }
        unsigned short ygv[16];
        if (FINAL) {
#pragma unroll
            for (int tile = 0; tile < 4; ++tile)
#pragma unroll
                for (int j = 0; j < 4; ++j) ygv[4 * tile + j] = YG[(size_t)(b * SEQ + t0 + 16 * tile + 4 * g + j) * RW + ch];
        }
#pragma unroll
        for (int e2 = 0; e2 < 2; ++e2) { float y[8];
#pragma unroll
            for (int e = 0; e < 8; ++e) y[e] = cb[e] + cw[0][e] * x[e2][e] + cw[1][e] * x[e2 + 1][e] + cw[2][e] * x[e2 + 2][e] + cw[3][e] * x[e2 + 3][e];
            const int tl = 2 * tp + e2;
            v4u pb; pb.x = pk2(y[0], y[1]); pb.y = pk2(y[2], y[3]); pb.z = pk2(y[4], y[5]); pb.w = pk2(y[6], y[7]);
            *(LAS v4u*)(xcb + (tl * RNN_XCB_RS + 8 * cg) * 2) = pb;
            *(LAS f32x4*)(xcf + tl * RNN_XCF_RS + 8 * cg) = (f32x4){y[0], y[1], y[2], y[3]}; *(LAS f32x4*)(xcf + tl * RNN_XCF_RS + 8 * cg + 4) = (f32x4){y[4], y[5], y[6], y[7]}; }
        __syncthreads();
        f32x4 ra[4], ia[4];
#pragma unroll
        for (int tile = 0; tile < 4; ++tile) { ra[tile] = (f32x4){0.f, 0.f, 0.f, 0.f}; ia[tile] = (f32x4){0.f, 0.f, 0.f, 0.f};
#pragma unroll
            for (int kk = 0; kk < 4; ++kk) { const bf16x8 af = *(const LAS bf16x8*)(xcb + ((16 * tile + i) * RNN_XCB_RS + 32 * kk + 8 * g) * 2);
                ra[tile] = __builtin_amdgcn_mfma_f32_16x16x32_bf16(af, wa[kk], ra[tile], 0, 0, 0); ia[tile] = __builtin_amdgcn_mfma_f32_16x16x32_bf16(af, wi[kk], ia[tile], 0, 0, 0); } }
#pragma unroll
        for (int tile = 0; tile < 4; ++tile) {
            float a[4], gx[4];
#pragma unroll
            for (int j = 0; j < 4; ++j) { const float xv = xcf[(16 * tile + 4 * g + j) * RNN_XCF_RS + chl];
                const float r = pg8::fast_sigmoid(ra[tile][j] + ba), ig = pg8::fast_sigmoid(ia[tile][j] + bi), la = -r * sp;
                a[j] = __builtin_amdgcn_exp2f(la); const float om = 1.0f - __builtin_amdgcn_exp2f(2.0f * la); gx[j] = __builtin_amdgcn_sqrtf(fmaxf(om, 0.f)) * (ig * xv); }
            const float As = (a[0] * a[1]) * (a[2] * a[3]); float Bs = gx[0]; Bs = a[1] * Bs + gx[1]; Bs = a[2] * Bs + gx[2]; Bs = a[3] * Bs + gx[3];
            float hin = hc, hend = hc;
#pragma unroll
            for (int gg = 0; gg < 4; ++gg) { const float Ag = __shfl(As, i + 16 * gg), Bg = __shfl(Bs, i + 16 * gg); if (gg < g) hin = Ag * hin + Bg; hend = Ag * hend + Bg; Atot *= Ag; }
            hc = hend;
            if (FINAL) { float hv[4]; hv[0] = a[0] * hin + gx[0]; hv[1] = a[1] * hv[0] + gx[1]; hv[2] = a[2] * hv[1] + gx[2]; hv[3] = a[3] * hv[2] + gx[3];
#pragma unroll
                for (int j = 0; j < 4; ++j) { const float yv = __builtin_bit_cast(float, (unsigned)ygv[4 * tile + j] << 16);
                    const float z = yv + 0.044715f * yv * yv * yv, ge = yv * __builtin_amdgcn_rcpf(1.0f + __builtin_amdgcn_exp2f(-2.0f * 0.7978845608f * LOG2E * z));
                    MIX[(size_t)(b * SEQ + t0 + 16 * tile + 4 * g + j) * D + AW + ch] = (bf16)(pk2(hv[j] * ge, 0.f) & 0xffffu); } }
        }
    }
    if (!FINAL && g == 0) AGG[((b * 16 + n) * 8 + kg) * 128 + chl] = make_float2(Atot, hc);
}

struct Args { const float* in[27]; float* out; unsigned char* ws; int ph_lo, ph_hi, li, pad; };
enum { I_X = 0, I_P, I_F1PRE, I_F1G, I_F1U, I_F1D, I_F1POST, I_MIXPRE, I_WIN, I_RELB, I_CONVW, I_CONVB, I_LWA, I_LBA, I_LWI, I_LBI, I_LAM, I_WOUT, I_MIXPOST, I_F2PRE, I_F2G, I_F2U, I_F2D, I_F2POST, I_PLEP, I_PLEG, I_PLEPOST };

__global__ void __launch_bounds__(NWAVES * 64, 2) mk_fwd(Args args) {
    extern __shared__ __attribute__((aligned(16))) unsigned char lds_raw[];
    LAS unsigned char* lds = (LAS unsigned char*)lds_raw;
    volatile LAS unsigned* MISC = (volatile LAS unsigned*)(lds + MISC_OFF);
    const int tid = threadIdx.x, lane = tid & 63, wave = __builtin_amdgcn_readfirstlane(tid >> 6);
    const int G = gridDim.x; const int bx = blockIdx.x; const int vcu = (G % 8 == 0) ? (bx % 8) * (G / 8) + bx / 8 : bx;
    unsigned char* ws = args.ws;
    gu32* ctl = (gu32*)(ws + WS_CTL);
    for (int u = tid; u < (LDS_BYTES - LDSCTL_OFF) / 4; u += NWAVES * 64) ((LAS unsigned*)(lds + LDSCTL_OFF))[u] = 0u;
    __syncthreads();
    XcdBarrier bar; bar.bar = (unsigned*)(ctl + CW_BAR); bar.x = 0; bar.st = nullptr;
    if (!MK_PER_PHASE) bar = xcd_barrier_post((unsigned*)(ctl + CW_BAR), MISC + 8);
#define GRID_BAR() do { if (!MK_PER_PHASE) xcd_barrier(bar); } while (0)
    const int lo = args.ph_lo, hi = args.ph_hi;
#define IN(k) (((MK_PHASE_MASK >> (k)) & 1) && lo <= (k) && (k) < hi)
#define BOTH(k) (IN(k) && IN((k) + 1))
    const float* x = args.in[I_X]; float* out = args.out;
    bf16* WG1 = (bf16*)(ws + WS_WG1); bf16* WD1 = (bf16*)(ws + WS_WD1); bf16* WG2 = (bf16*)(ws + WS_WG2); bf16* WD2 = (bf16*)(ws + WS_WD2);
    bf16* WIN = (bf16*)(ws + WS_WIN); bf16* WOUT = (bf16*)(ws + WS_WOUT); bf16* WPG = (bf16*)(ws + WS_WPG); bf16* WPP = (bf16*)(ws + WS_WPP);
    bf16* LWA = (bf16*)(ws + WS_LWA); bf16* LWI = (bf16*)(ws + WS_LWI); bf16* PB = (bf16*)(ws + WS_PB);
    bf16* ABUF = (bf16*)(ws + WS_ABUF); bf16* ACT = (bf16*)(ws + WS_ACT); bf16* MIX = (bf16*)(ws + WS_MIX);
    bf16* QB = (bf16*)(ws + WS_Q); bf16* KB = (bf16*)(ws + WS_K); bf16* VT = (bf16*)(ws + WS_VT); bf16* XR = (bf16*)(ws + WS_XR); bf16* YG = (bf16*)(ws + WS_YG);
    float* FB = (float*)(ws + WS_F); float* EP = (float*)(ws + WS_EP); float2* AGG = (float2*)(ws + WS_AGG);
    const int gw = vcu * NWAVES + wave, NGW = G * NWAVES;

    if (IN(0)) {
        LAS float* scr = (LAS float*)(lds + wave * 16384);
        constexpr int T_FG = (D / 64) * (FF / 64), T_FD = (FF / 64) * (D / 64), T_IN = (D / 64) * (NIN / 64), T_SQ = (D / 64) * (D / 64), T_PP = (PLE / 64) * (D / 64), T_L = 16 * 4;
        constexpr int NITEMS = 6 * T_FG + T_IN + 2 * T_SQ + T_PP + 2 * T_L;
        static_assert(T_FG == T_FD, "ffn tiles");
        for (int it = gw; it < NITEMS; it += NGW) {
            int r = it;
#define TR_FFN_GU(SRC, DST, UP) if (r < T_FG) { const int kb = r / (FF / 64), nb = r % (FF / 64), n0 = 64 * nb; tr_item(args.in[SRC], FF, DST, D, 64 * kb, n0, (n0 >> 7) * 256 + (n0 & 127) + (UP ? 128 : 0), scr, lane); continue; } r -= T_FG;
#define TR_PLAIN(SRC, DST, KK, NN) if (r < ((KK) / 64) * ((NN) / 64)) { const int kb = r / ((NN) / 64), nb = r % ((NN) / 64); tr_item(args.in[SRC], NN, DST, KK, 64 * kb, 64 * nb, 64 * nb, scr, lane); continue; } r -= ((KK) / 64) * ((NN) / 64);
            TR_FFN_GU(I_F2G, WG2, 0)
            TR_FFN_GU(I_F2U, WG2, 1)
            TR_PLAIN(I_F2D, WD2, FF, D)
            TR_PLAIN(I_PLEG, WPG, D, D)
            TR_PLAIN(I_PLEP, WPP, PLE, D)
            TR_PLAIN(I_WOUT, WOUT, D, D)
            if (r < T_L) { const int blk = r >> 2, kb = (r >> 1) & 1, nb = r & 1; tr_item(args.in[I_LWA] + blk * 16384, 128, LWA + blk * 16384, 128, 64 * kb, 64 * nb, 64 * nb, scr, lane); continue; } r -= T_L;
            if (r < T_L) { const int blk = r >> 2, kb = (r >> 1) & 1, nb = r & 1; tr_item(args.in[I_LWI] + blk * 16384, 128, LWI + blk * 16384, 128, 64 * kb, 64 * nb, 64 * nb, scr, lane); continue; } r -= T_L;
            TR_PLAIN(I_WIN, WIN, D, NIN)
            TR_PLAIN(I_F1D, WD1, FF, D)
            TR_FFN_GU(I_F1G, WG1, 0)
            TR_FFN_GU(I_F1U, WG1, 1)
#undef TR_FFN_GU
#undef TR_PLAIN
        }
        { const float* p = args.in[I_P]; const int gt = gw * 64 + lane, NGT = NGW * 64;
          for (int c8 = gt; c8 < M * PLE / 8; c8 += NGT) { const f32x4 a = ((const GAS f32x4*)p)[2 * c8], b2 = ((const GAS f32x4*)p)[2 * c8 + 1];
              v4u o; o.x = pk2(a.x, a.y); o.y = pk2(a.z, a.w); o.z = pk2(b2.x, b2.y); o.w = pk2(b2.z, b2.w); ((GAS v4u*)PB)[c8] = o; } }
        row_phase<false, true, false, true>(lds, nullptr, x, nullptr, 0.f, args.in[I_F1PRE], nullptr, ABUF, gw, NGW, lane, tid);
        if (BOTH(0)) GRID_BAR();
    }
    if (IN(1)) {
        pg8::Gemm g{ABUF, WG1, M, 2 * FF, D}; pg8::StaticOrder S; S.init(M, 2 * FF, G, bx);
        pg8::EpiSwiGLU E{ACT, FF};
        pg8::gemm_phase<pg8::EpiSwiGLU, pg8::StaticOrder, true, true>(lds, g, S, E);
        if (BOTH(1)) GRID_BAR();
    }
    if (IN(2)) {
        pg8::Gemm g{ACT, WD1, M, D, FF}; pg8::StaticOrder S; S.init(M, D, G, bx);
        pg8::EpiF32 E{FB, D};
        pg8::gemm_phase<pg8::EpiF32, pg8::StaticOrder, true, true>(lds, g, S, E);
        if (BOTH(2)) GRID_BAR();
    }
    if (IN(3)) {
        row_phase<true, true, true, true>(lds, FB, x, args.in[I_F1POST], 0.5f, args.in[I_MIXPRE], out, ABUF, gw, NGW, lane, tid);
        if (BOTH(3)) GRID_BAR();
    }
    if (IN(4)) {
        pg8::Gemm g{ABUF, WIN, M, NIN, D}; pg8::StaticOrder S; S.init(M, NIN, G, bx);
        pg8::EpiWin E{QB, KB, VT, XR, YG, 0.08838834764831845f * LOG2E};
        pg8::gemm_phase<pg8::EpiWin, pg8::StaticOrder, true, true>(lds, g, S, E);
        if (BOTH(4)) GRID_BAR();
    }
    if (IN(5)) {
        const int u0 = (int)(((long)vcu * 2048) / G), u1 = (int)(((long)(vcu + 1) * 2048) / G);
        for (int u = u0; u < u1; ++u) { const int bh = u >> 6; attn_unit(lds, QB, KB, VT, args.in[I_RELB], MIX, bh >> 4, bh & 15, u & 63, tid, wave, lane); }
        __syncthreads();
        const int g0 = (int)(((long)vcu * 256) / G), g1 = (int)(((long)(vcu + 1) * 256) / G);
        for (int gi = g0; gi < g1; ++gi) { rnn_group<false>(lds, XR, YG, args.in[I_CONVW], args.in[I_CONVB], LWA, LWI, args.in[I_LBA], args.in[I_LBI], args.in[I_LAM], AGG, MIX, gi >> 7, (gi >> 3) & 15, gi & 7, tid, wave, lane); __syncthreads(); }
        if (BOTH(5)) GRID_BAR();
    }
    if (IN(6)) {
        const int g0 = (int)(((long)vcu * 256) / G), g1 = (int)(((long)(vcu + 1) * 256) / G);
        for (int gi = g0; gi < g1; ++gi) { rnn_group<true>(lds, XR, YG, args.in[I_CONVW], args.in[I_CONVB], LWA, LWI, args.in[I_LBA], args.in[I_LBI], args.in[I_LAM], AGG, MIX, gi >> 7, (gi >> 3) & 15, gi & 7, tid, wave, lane); __syncthreads(); }
        if (BOTH(6)) GRID_BAR();
    }
    if (IN(7)) {
        pg8::Gemm g{MIX, WOUT, M, D, D}; pg8::StaticOrder S; S.init(M, D, G, bx);
        pg8::EpiF32 E{FB, D};
        pg8::gemm_phase<pg8::EpiF32, pg8::StaticOrder, true, true>(lds, g, S, E);
        if (BOTH(7)) GRID_BAR();
    }
    if (IN(8)) {
        row_phase<true, true, true, true>(lds, FB, out, args.in[I_MIXPOST], 1.0f, args.in[I_F2PRE], out, ABUF, gw, NGW, lane, tid);
        if (BOTH(8)) GRID_BAR();
    }
    if (IN(9)) {
        pg8::Gemm g{ABUF, WG2, M, 2 * FF, D}; pg8::StaticOrder S; S.init(M, 2 * FF, G, bx);
        pg8::EpiSwiGLU E{ACT, FF};
        pg8::gemm_phase<pg8::EpiSwiGLU, pg8::StaticOrder, true, true>(lds, g, S, E);
        if (BOTH(9)) GRID_BAR();
    }
    if (IN(10)) {
        pg8::Gemm g{ACT, WD2, M, D, FF}; pg8::StaticOrder S; S.init(M, D, G, bx);
        pg8::EpiF32 E{FB, D};
        pg8::gemm_phase<pg8::EpiF32, pg8::StaticOrder, true, true>(lds, g, S, E);
        if (BOTH(10)) GRID_BAR();
    }
    if (IN(11)) {
        row_phase<true, false, true, true>(lds, FB, out, args.in[I_F2POST], 0.5f, nullptr, out, ABUF, gw, NGW, lane, tid);
        if (BOTH(11)) GRID_BAR();
    }
    if (IN(12)) {
        { int kple = PLE; asm volatile("" : "+s"(kple));
          pg8::Gemm g{PB, WPP, M, D, kple}; pg8::StaticOrder S; S.init(M, D, G, bx); pg8::EpiF32 E{EP, D};
          pg8::gemm_phase<pg8::EpiF32, pg8::StaticOrder, true, true>(lds, g, S, E); }
    }
    if (IN(12)) {
        { pg8::Gemm g{ABUF, WPG, M, D, D}; pg8::StaticOrder S; S.init(M, D, G, bx); pg8::EpiPle E{EP, FB, D};
          pg8::gemm_phase<pg8::EpiPle, pg8::StaticOrder, true, true>(lds, g, S, E); }
        if (BOTH(12)) GRID_BAR();
    }
    if (IN(13)) {
        row_phase<true, false, true, false>(lds, FB, out, args.in[I_PLEPOST], 1.0f, nullptr, out, nullptr, gw, NGW, lane, tid);
    }
#undef IN
#undef BOTH
#undef GRID_BAR
}

extern "C" void kernel_launch(void* const* d_in, const int* in_sizes, int n_in, void* d_out, int out_size, void* d_ws, size_t ws_size, hipStream_t stream) {
    static int grid = 0;
    if (grid == 0) {
        if (n_in != 27 || in_sizes[0] != M * D || out_size != M * D || ws_size < WS_END) { fprintf(stderr, "kernel_launch: unexpected shapes / workspace (n_in %d, in0 %d, out %d, ws %zu < %zu); nothing launched\n", n_in, n_in > 0 ? in_sizes[0] : -1, out_size, ws_size, (size_t)WS_END); grid = -1; return; }
        int dev = 0, cus = 0, per_cu = 0;
        if (hipGetDevice(&dev) != hipSuccess || hipDeviceGetAttribute(&cus, hipDeviceAttributeMultiprocessorCount, dev) != hipSuccess) { fprintf(stderr, "kernel_launch: device query failed\n"); grid = -1; return; }
        if (hipFuncSetAttribute((const void*)mk_fwd, hipFuncAttributeMaxDynamicSharedMemorySize, LDS_BYTES) != hipSuccess) { fprintf(stderr, "kernel_launch: hipFuncSetAttribute failed\n"); grid = -1; return; }
        if (hipOccupancyMaxActiveBlocksPerMultiprocessor(&per_cu, (const void*)mk_fwd, NWAVES * 64, LDS_BYTES) != hipSuccess || per_cu < 1) fprintf(stderr, "kernel_launch: note: occupancy query reports %d workgroups per CU\n", per_cu);
        (void)hipGetLastError();
        grid = cus;
    }
    if (grid < 0) return;
    if (hipMemsetAsync((char*)d_ws + WS_CTL, 0, CTL_ZERO_BYTES, stream) != hipSuccess) { fprintf(stderr, "kernel_launch: memset failed\n"); return; }
    Args a{};
    for (int i = 0; i < 27; ++i) a.in[i] = (const float*)d_in[i];
    a.out = (float*)d_out; a.ws = (unsigned char*)d_ws;
#if MK_PER_PHASE
    for (int li = 0; li < MK_PH_HI; ++li) { a.ph_lo = li; a.ph_hi = li + 1; a.li = li;
        hipLaunchKernelGGL(mk_fwd, dim3(grid), dim3(NWAVES * 64), LDS_BYTES, stream, a); }
#else
    a.ph_lo = 0; a.ph_hi = MK_PH_HI; a.li = 0;
    hipLaunchKernelGGL(mk_fwd, dim3(grid), dim3(NWAVES * 64), LDS_BYTES, stream, a);
#endif
    const hipError_t le = hipPeekAtLastError();
    if (le != hipSuccess) fprintf(stderr, "kernel_launch: launch failed: %s\n", hipGetErrorName(le));
}
```
